# Optimizing an MI355X kernel written in HIP

```python
import math
import jax, jax.numpy as jnp
from jax import lax
import numpy as np

D_MODEL = 1024
BATCH = 16
SEQ = 2048
DEPTH = 1

CHUNK = 64
Q_BLOCK = 128
ATTN_HEADS = 4
HEAD_DIM = 64
ATTN_WIDTH = ATTN_HEADS * 2 * HEAD_DIM
CONV_CH = 512
CONV_WIDTH = 31
FFN_DIM = 2816
FFN_CONV_WIDTH = 3
LN_EPS = 1e-5
DEEPNORM_ALPHA = (2.0 * DEPTH) ** 0.25
DEEPNORM_BETA = (8.0 * DEPTH) ** -0.25
IN_COLS = 3 * ATTN_WIDTH + 2 * CONV_CH + 2 * D_MODEL

kernel_name = "diffattn_conformer_gated_hybrid_deepnorm"


def layer_norm(x, g, b):
    x32 = x.astype(jnp.float32)
    mu = jnp.mean(x32, axis=-1, keepdims=True)
    var = jnp.mean(jnp.square(x32 - mu), axis=-1, keepdims=True)
    y = (x32 - mu) * lax.rsqrt(var + LN_EPS) * g.astype(jnp.float32) + b.astype(jnp.float32)
    return y.astype(x.dtype)


def causal_dwconv(x, w, b):
    k_width, ch = w.shape
    y = lax.conv_general_dilated(
        x, w.astype(x.dtype)[:, None, :], window_strides=(1,), padding=[(k_width - 1, 0)],
        dimension_numbers=('NWC', 'WIO', 'NWC'), feature_group_count=ch)
    return y + b.astype(x.dtype)


def diff_attention(q, k, v, lam, lambda_init, sub_gain):
    bsz, seq = q.shape[0], q.shape[1]
    scale = HEAD_DIM ** -0.5
    slopes = jnp.exp2(-8.0 * jnp.arange(1, ATTN_HEADS + 1, dtype=jnp.float32) / ATTN_HEADS)
    kpos = jnp.arange(seq)

    def block(i):
        start = i * Q_BLOCK
        qb = lax.dynamic_slice_in_dim(q, start, Q_BLOCK, axis=1)
        qpos = start + jnp.arange(Q_BLOCK)
        s = jnp.einsum('bqhmd,bkhmd->bhmqk', qb, k).astype(jnp.float32) * scale
        dist = jnp.abs(qpos[:, None] - kpos[None, :]).astype(jnp.float32)
        bias = -slopes[:, None, None] * dist
        allowed = (kpos[None, :] // CHUNK) <= (qpos[:, None] // CHUNK)
        s = jnp.where(allowed, s + bias[None, :, None], -jnp.inf)
        p = jax.nn.softmax(s, axis=-1)
        a = p[:, :, 0] - lam * p[:, :, 1]
        o = jnp.einsum('bhqk,bkhe->bqhe', a.astype(v.dtype), v)
        o32 = o.astype(jnp.float32)
        o32 = o32 * lax.rsqrt(jnp.mean(jnp.square(o32), axis=-1, keepdims=True) + LN_EPS)
        o32 = o32 * sub_gain.astype(jnp.float32) * (1.0 - lambda_init)
        return o32.astype(v.dtype)

    out = lax.map(block, jnp.arange(seq // Q_BLOCK))
    out = jnp.moveaxis(out, 0, 1)
    return out.reshape(bsz, seq, ATTN_WIDTH)


def setup_inputs(seed: int = 0) -> dict:
    key = jax.random.key(seed)
    ks = jax.random.split(key, 24)
    L, D, A, C, F = DEPTH, D_MODEL, ATTN_WIDTH, CONV_CH, FFN_DIM
    beta = DEEPNORM_BETA
    nrm = lambda k, shape: jax.random.normal(k, shape, dtype=jnp.float32)
    col_scale = jnp.concatenate([
        jnp.ones((2 * A,), jnp.float32),
        jnp.full((A,), beta, jnp.float32),
        jnp.ones((2 * C + 2 * D,), jnp.float32),
    ])
    return {
        "x": nrm(ks[0], (BATCH, SEQ, D)),
        "w_in": nrm(ks[1], (L, D, IN_COLS)) * (D ** -0.5) * col_scale,
        "b_gate": 0.02 * nrm(ks[2], (L, 2 * D)),
        "lambda_q1": 0.1 * nrm(ks[3], (L, HEAD_DIM)),
        "lambda_k1": 0.1 * nrm(ks[4], (L, HEAD_DIM)),
        "lambda_q2": 0.1 * nrm(ks[5], (L, HEAD_DIM)),
        "lambda_k2": 0.1 * nrm(ks[6], (L, HEAD_DIM)),
        "subln_gain": 1.0 + 0.02 * nrm(ks[7], (L, 2 * HEAD_DIM)),
        "w_attn_proj": nrm(ks[8], (L, A, D)) * (A ** -0.5) * beta,
        "conv_dw_w": nrm(ks[9], (L, CONV_WIDTH, C)) * (CONV_WIDTH ** -0.5),
        "conv_dw_b": 0.02 * nrm(ks[10], (L, C)),
        "conv_ln_g": 1.0 + 0.02 * nrm(ks[11], (L, C)),
        "conv_ln_b": 0.02 * nrm(ks[12], (L, C)),
        "w_conv_proj": nrm(ks[13], (L, C, D)) * (C ** -0.5) * beta,
        "b_conv_proj": 0.02 * nrm(ks[14], (L, D)),
        "w_out": nrm(ks[15], (L, D, D)) * (D ** -0.5) * beta,
        "ln1_g": 1.0 + 0.02 * nrm(ks[16], (L, D)),
        "ln1_b": 0.02 * nrm(ks[17], (L, D)),
        "w_ffn_in": nrm(ks[18], (L, D, 2 * F)) * (D ** -0.5) * beta,
        "ffn_dw_w": nrm(ks[19], (L, FFN_CONV_WIDTH, F)) * (FFN_CONV_WIDTH ** -0.5),
        "ffn_dw_b": 0.02 * nrm(ks[20], (L, F)),
        "w_ffn_down": nrm(ks[21], (L, F, D)) * (F ** -0.5) * beta,
        "ln2_g": 1.0 + 0.02 * nrm(ks[22], (L, D)),
        "ln2_b": 0.02 * nrm(ks[23], (L, D)),
    }


def reference(x, w_in, b_gate, lambda_q1, lambda_k1, lambda_q2, lambda_k2, subln_gain,
              w_attn_proj, conv_dw_w, conv_dw_b, conv_ln_g, conv_ln_b, w_conv_proj, b_conv_proj,
              w_out, ln1_g, ln1_b, w_ffn_in, ffn_dw_w, ffn_dw_b, w_ffn_down, ln2_g, ln2_b):
    bsz, seq = x.shape[0], x.shape[1]
    A, C, D, F = ATTN_WIDTH, CONV_CH, D_MODEL, FFN_DIM
    for l in range(DEPTH):
        lambda_init = 0.8 - 0.6 * math.exp(-0.3 * l)
        proj = jnp.einsum('bsd,dc->bsc', x, w_in[l])
        q, k, v, glu, g = jnp.split(proj, [A, 2 * A, 3 * A, 3 * A + 2 * C], axis=-1)
        q = q.reshape(bsz, seq, ATTN_HEADS, 2, HEAD_DIM)
        k = k.reshape(bsz, seq, ATTN_HEADS, 2, HEAD_DIM)
        v = v.reshape(bsz, seq, ATTN_HEADS, 2 * HEAD_DIM)
        gates = jax.nn.sigmoid((g + b_gate[l]).astype(jnp.float32)).astype(x.dtype)
        g_attn, g_conv = jnp.split(gates, 2, axis=-1)

        lam = (jnp.exp(jnp.sum(lambda_q1[l].astype(jnp.float32) * lambda_k1[l].astype(jnp.float32)))
               - jnp.exp(jnp.sum(lambda_q2[l].astype(jnp.float32) * lambda_k2[l].astype(jnp.float32)))
               + lambda_init)
        attn = diff_attention(q, k, v, lam, lambda_init, subln_gain[l])
        attn = jnp.einsum('bsa,ad->bsd', attn, w_attn_proj[l])

        u = glu[..., :C] * jax.nn.sigmoid(glu[..., C:])
        u = causal_dwconv(u, conv_dw_w[l], conv_dw_b[l])
        u = jax.nn.silu(layer_norm(u, conv_ln_g[l], conv_ln_b[l]))
        conv = jnp.einsum('bsc,cd->bsd', u, w_conv_proj[l]) + b_conv_proj[l]

        mixed = g_attn * attn + g_conv * conv
        y = jnp.einsum('bsd,de->bse', mixed, w_out[l])
        x = layer_norm(DEEPNORM_ALPHA * x + y, ln1_g[l], ln1_b[l])

        up = jnp.einsum('bsd,df->bsf', x, w_ffn_in[l])
        gate, val = jnp.split(up, [F], axis=-1)
        gate = causal_dwconv(gate, ffn_dw_w[l], ffn_dw_b[l])
        hid = jax.nn.gelu(gate, approximate=False) * val
        f = jnp.einsum('bsf,fd->bsd', hid, w_ffn_down[l])
        x = layer_norm(DEEPNORM_ALPHA * x + f, ln2_g[l], ln2_b[l])
    return x
```

```cpp
#include <hip/hip_runtime.h>
#include <hip/hip_cooperative_groups.h>
#include <cstdio>
#include <cstdint>
namespace cg = cooperative_groups;
namespace pg8 {
#define PG8_LAS __attribute__((address_space(3)))
typedef unsigned short bf16_t;
typedef short bf16x8 __attribute__((ext_vector_type(8)));
typedef float f32x4 __attribute__((ext_vector_type(4)));
typedef unsigned u32x4 __attribute__((ext_vector_type(4)));
constexpr int BM = 256, BK = 64, HALF = 128, HTB = HALF * BK * 2  , STAGE_BYTES = 8 * HTB, NXCD = 8, WGM = 8;

__host__ __device__ __forceinline__ int lds_byte(int r, int c) { const int st = (r >> 4) * 2 + (c >> 5), rr = r & 15, cc = c & 31, ob = rr * 64 + cc * 2; return st * 1024 + (ob ^ (((ob >> 9) & 1) << 5)); }
__host__ __device__ __forceinline__ void stage_rc(int b, int& R, int& C) { const int st = b / 1024, sb = b % 1024, swz = sb ^ (((sb >> 9) & 1) << 5); R = (st >> 1) * 16 + swz / 64; C = (st & 1) * 32 + (swz % 64) / 2; }
__host__ __device__ __forceinline__ int perm32(int rho) { const int n = rho >> 4, i = rho & 15; return 8 * (i >> 2) + 4 * n + (i & 3); }

struct Unit { int pm, pn; };
struct Gemm { const bf16_t* A; const bf16_t* Bt; int M, N, K; const bf16_t* A2; int pn2; };

struct StaticOrder {
    int nM, nN, nwg, G, c;
    __host__ __device__ void init(int M, int N, int G_, int c_) { nM = M / BM; nN = N / BM; nwg = nM * nN; G = G_; c = c_; }
    __host__ __device__ bool next(int i, Unit& u) const {
        const long L = (long)i * G + c; if (L >= nwg) return false;
        int wgid = (int)L; { const int q = nwg / NXCD, r = nwg % NXCD, xcd = wgid % NXCD, off = wgid / NXCD; wgid = (xcd < r ? xcd * (q + 1) : r * (q + 1) + (xcd - r) * q) + off; }
        const int nig = WGM * nN, gid = wgid / nig, fm = gid * WGM, gsz = (nM - fm) < WGM ? (nM - fm) : WGM;
        u.pm = fm + ((wgid % nig) % gsz); u.pn = (wgid % nig) / gsz; return true;
    }
    __device__ __forceinline__ void a_ready(const Unit&) const {}
    __device__ __forceinline__ void done(const Unit&) const {}
};

typedef float f32x2cv __attribute__((ext_vector_type(2))); typedef __bf16 bf16x2cv __attribute__((ext_vector_type(2)));
__device__ __forceinline__ unsigned cvt_pk_bf16(float lo, float hi) { const f32x2cv v = {lo, hi}; const bf16x2cv b = __builtin_convertvector(v, bf16x2cv); return __builtin_bit_cast(unsigned, b); }
typedef float f32x2 __attribute__((ext_vector_type(2)));
__device__ __forceinline__ f32x2 gelu_pk(f32x2 v) {
    const f32x2 av = __builtin_elementwise_abs(v), d = av * 0.2316418882f + 1.0f;
    f32x2 t; t.x = __builtin_amdgcn_rcpf(d.x); t.y = __builtin_amdgcn_rcpf(d.y);
    f32x2 q = t * 0.5307027145f + (-0.7265760135f); q = q * t + 0.7107068705f; q = q * t + (-0.142248368f); q = q * t + 0.127414796f; q = q * t;
    const f32x2 s = (v * v) * (-0.72134752044f);
    f32x2 e; e.x = __builtin_amdgcn_exp2f(s.x); e.y = __builtin_amdgcn_exp2f(s.y);
    const f32x2 m = v * (q * e), r = v - m;
    f32x2 o; o.x = v.x < 0.f ? m.x : r.x; o.y = v.y < 0.f ? m.y : r.y; return o;
}
constexpr int MTOK = 32768, SEQ = 2048, DM = 1024, AW = 512, CC = 512, FF = 2816, NIN = 4608;
constexpr float ALPHA = 1.189207115002721f;
constexpr float LN_EPS = 1e-5f;
constexpr float QSCALE = 0.125f * 1.4426950408889634f;
typedef unsigned u32x4 __attribute__((ext_vector_type(4)));
typedef unsigned u32x2 __attribute__((ext_vector_type(2)));
__device__ __forceinline__ float bflo(unsigned w) { return __uint_as_float(w << 16); }
__device__ __forceinline__ float bfhi(unsigned w) { return __uint_as_float(w & 0xffff0000u); }
__device__ __forceinline__ float sigmoidf_(float x) { return __builtin_amdgcn_rcpf(1.0f + __expf(-x)); }
template <int CTRL> __device__ __forceinline__ float dppf(float v) { return __builtin_bit_cast(float, __builtin_amdgcn_update_dpp(0, __builtin_bit_cast(int, v), CTRL, 0xf, 0xf, false)); }

struct EpiProj {
    static constexpr bool PERM = true, AFTER_DRAIN = false;
    bf16_t *Q, *Kb, *Vb, *U, *G; const float* bgate;
    __device__ __forceinline__ void operator()(const f32x4 (&acc)[2][2][4][2], const Unit& u, int wr, int wc, int fr, int fq) const {
        const int pn = u.pn; const int row0 = u.pm * BM + wr * 64 + fr;
        if (pn < 6) {
            bf16_t* base = Q + (size_t)(pn >> 1) * ((size_t)MTOK * AW);     const float sc = pn < 2 ? QSCALE : 1.0f; const int col0 = (pn & 1) * 256 + wc * 32 + 8 * fq;
#pragma unroll
            for (int ai = 0; ai < 2; ++ai)
#pragma unroll
                for (int m = 0; m < 4; ++m) { bf16_t* rowp = base + (size_t)(row0 + ai * HALF + m * 16) * AW + col0;
#pragma unroll
                    for (int bj = 0; bj < 2; ++bj) { const f32x4 v0 = acc[ai][bj][m][0] * sc, v1 = acc[ai][bj][m][1] * sc; u32x4 w;
                        w.x = cvt_pk_bf16(v0[0], v0[1]); w.y = cvt_pk_bf16(v0[2], v0[3]); w.z = cvt_pk_bf16(v1[0], v1[1]); w.w = cvt_pk_bf16(v1[2], v1[3]);
                        *(u32x4*)(rowp + bj * HALF) = w; } }
        } else if (pn < 10) {
            const int col0 = (pn - 6) * 128 + wc * 32 + 8 * fq;
#pragma unroll
            for (int ai = 0; ai < 2; ++ai)
#pragma unroll
                for (int m = 0; m < 4; ++m) { bf16_t* rowp = U + (size_t)(row0 + ai * HALF + m * 16) * CC + col0; float o[8];
#pragma unroll
                    for (int n = 0; n < 2; ++n)
#pragma unroll
                        for (int e = 0; e < 4; ++e) o[4 * n + e] = acc[ai][0][m][n][e] * sigmoidf_(acc[ai][1][m][n][e]);
                    u32x4 w; w.x = cvt_pk_bf16(o[0], o[1]); w.y = cvt_pk_bf16(o[2], o[3]); w.z = cvt_pk_bf16(o[4], o[5]); w.w = cvt_pk_bf16(o[6], o[7]);
                    *(u32x4*)rowp = w; }
        } else {
            const int col0 = (pn - 10) * 256 + wc * 32 + 8 * fq;
            f32x4 bv[2][2];
#pragma unroll
            for (int bj = 0; bj < 2; ++bj)
#pragma unroll
                for (int n = 0; n < 2; ++n) bv[bj][n] = *(const f32x4*)(bgate + col0 + bj * HALF + 4 * n);
#pragma unroll
            for (int ai = 0; ai < 2; ++ai)
#pragma unroll
                for (int m = 0; m < 4; ++m) { bf16_t* rowp = G + (size_t)(row0 + ai * HALF + m * 16) * (2 * DM) + col0;
#pragma unroll
                    for (int bj = 0; bj < 2; ++bj) { const f32x4 v0 = acc[ai][bj][m][0] + bv[bj][0], v1 = acc[ai][bj][m][1] + bv[bj][1]; u32x4 w;
                        w.x = cvt_pk_bf16(sigmoidf_(v0[0]), sigmoidf_(v0[1])); w.y = cvt_pk_bf16(sigmoidf_(v0[2]), sigmoidf_(v0[3]));
                        w.z = cvt_pk_bf16(sigmoidf_(v1[0]), sigmoidf_(v1[1])); w.w = cvt_pk_bf16(sigmoidf_(v1[2]), sigmoidf_(v1[3]));
                        *(u32x4*)(rowp + bj * HALF) = w; } }
        }
    }
};
struct EpiMix {
    static constexpr bool PERM = true, AFTER_DRAIN = false;
    const bf16_t* G; bf16_t* MX; const float* bconv;
    __device__ __forceinline__ void operator()(const f32x4 (&acc)[2][2][4][2], const Unit& u, int wr, int wc, int fr, int fq) const {
        const int pn4 = u.pn & 3; const bool second = u.pn >= 4; const int row0 = u.pm * BM + wr * 64 + fr; const int col0 = pn4 * 256 + wc * 32 + 8 * fq;
        f32x4 bv[2][2];
#pragma unroll
        for (int bj = 0; bj < 2; ++bj)
#pragma unroll
            for (int n = 0; n < 2; ++n) bv[bj][n] = second ? *(const f32x4*)(bconv + col0 + bj * HALF + 4 * n) : (f32x4){0.f, 0.f, 0.f, 0.f};
#pragma unroll
        for (int ai = 0; ai < 2; ++ai)
#pragma unroll
            for (int m = 0; m < 4; ++m) { const size_t row = (size_t)(row0 + ai * HALF + m * 16);
#pragma unroll
                for (int bj = 0; bj < 2; ++bj) {
                    const u32x4 g = *(const u32x4*)(G + row * (2 * DM) + (second ? DM : 0) + col0 + bj * HALF);
                    bf16_t* mp = MX + row * DM + col0 + bj * HALF;
                    const f32x4 v0 = acc[ai][bj][m][0] + bv[bj][0], v1 = acc[ai][bj][m][1] + bv[bj][1];
                    float o[8] = {bflo(g.x) * v0[0], bfhi(g.x) * v0[1], bflo(g.y) * v0[2], bfhi(g.y) * v0[3], bflo(g.z) * v1[0], bfhi(g.z) * v1[1], bflo(g.w) * v1[2], bfhi(g.w) * v1[3]};
                    if (second) { const u32x4 p = *(const u32x4*)mp;
                        o[0] += bflo(p.x); o[1] += bfhi(p.x); o[2] += bflo(p.y); o[3] += bfhi(p.y); o[4] += bflo(p.z); o[5] += bfhi(p.z); o[6] += bflo(p.w); o[7] += bfhi(p.w); }
                    u32x4 w; w.x = cvt_pk_bf16(o[0], o[1]); w.y = cvt_pk_bf16(o[2], o[3]); w.z = cvt_pk_bf16(o[4], o[5]); w.w = cvt_pk_bf16(o[6], o[7]);
                    *(u32x4*)mp = w; } }
    }
};
struct MixOrder {
    int G, c;
    __device__ bool next(int i, Unit& u) const { const int L = (i >> 1) * G + c; if (L >= (MTOK / BM) * 4) return false; u.pm = L >> 2; u.pn = (L & 3) + 4 * (i & 1); return true; }
    __device__ __forceinline__ void a_ready(const Unit&) const {}
    __device__ __forceinline__ void done(const Unit&) const {}
};
struct EpiRes {
    static constexpr bool PERM = true, AFTER_DRAIN = false;
    const float* R; float* Z;
    __device__ __forceinline__ void operator()(const f32x4 (&acc)[2][2][4][2], const Unit& u, int wr, int wc, int fr, int fq) const {
        const int row0 = u.pm * BM + wr * 64 + fr; const int col0 = u.pn * BM + wc * 32 + 8 * fq;
#pragma unroll
        for (int ai = 0; ai < 2; ++ai)
#pragma unroll
            for (int m = 0; m < 4; ++m) { const size_t off = (size_t)(row0 + ai * HALF + m * 16) * DM + col0;
#pragma unroll
                for (int bj = 0; bj < 2; ++bj)
#pragma unroll
                    for (int n = 0; n < 2; ++n) { const f32x4 r = *(const f32x4*)(R + off + bj * HALF + 4 * n); *(f32x4*)(Z + off + bj * HALF + 4 * n) = r * ALPHA + acc[ai][bj][m][n]; } }
    }
};
struct EpiFfn {
    static constexpr bool PERM = true, AFTER_DRAIN = false;
    bf16_t* H; const float* dww; const float* dwb; float* FIXG; float* FIXV; float* HALO;
    __device__ __forceinline__ void operator()(const f32x4 (&acc)[2][2][4][2], const Unit& u, int wr, int wc, int fr, int fq) const {
        const int col0 = u.pn * 128 + wc * 32 + 8 * fq; const int row0 = u.pm * BM + wr * 64 + fr;
        f32x4 w0[2], w1[2], w2[2], bb[2];
#pragma unroll
        for (int n = 0; n < 2; ++n) { w0[n] = *(const f32x4*)(dww + col0 + 4 * n); w1[n] = *(const f32x4*)(dww + FF + col0 + 4 * n); w2[n] = *(const f32x4*)(dww + 2 * FF + col0 + 4 * n); bb[n] = *(const f32x4*)(dwb + col0 + 4 * n); }
#pragma unroll
        for (int ai = 0; ai < 2; ++ai) { const int blk = u.pm * 4 + ai * 2 + wr;
#pragma unroll
            for (int m = 0; m < 4; ++m) { float o[8];
#pragma unroll
                for (int n = 0; n < 2; ++n)
#pragma unroll
                    for (int e = 0; e < 4; ++e) { const float g0 = acc[ai][0][m][n][e]; const float gp = acc[ai][0][m > 0 ? m - 1 : 0][n][e];
                        const float a1 = dppf<0x121>(g0), b1 = dppf<0x121>(gp), a2 = dppf<0x122>(g0), b2 = dppf<0x122>(gp);
                        const float p1 = fr >= 1 ? a1 : b1, p2 = fr >= 2 ? a2 : b2;
                        const float gc = bb[n][e] + w0[n][e] * p2 + w1[n][e] * p1 + w2[n][e] * g0;
                        o[4 * n + e] = gc; }
                { f32x2 a = gelu_pk((f32x2){o[0], o[1]}), b = gelu_pk((f32x2){o[2], o[3]}), c = gelu_pk((f32x2){o[4], o[5]}), d = gelu_pk((f32x2){o[6], o[7]});
                  const f32x4 v0 = acc[ai][1][m][0], v1 = acc[ai][1][m][1];
                  u32x4 w; w.x = cvt_pk_bf16(a.x * v0[0], a.y * v0[1]); w.y = cvt_pk_bf16(b.x * v0[2], b.y * v0[3]); w.z = cvt_pk_bf16(c.x * v1[0], c.y * v1[1]); w.w = cvt_pk_bf16(d.x * v1[2], d.y * v1[3]);
                  *(u32x4*)(H + (size_t)(row0 + ai * HALF + m * 16) * FF + col0) = w; }
                if (m == 0 && fr < 2) { float* pg = FIXG + ((size_t)blk * 2 + fr) * FF + col0; float* pv = FIXV + ((size_t)blk * 2 + fr) * FF + col0;
                    *(f32x4*)pg = acc[ai][0][0][0]; *(f32x4*)(pg + 4) = acc[ai][0][0][1]; *(f32x4*)pv = acc[ai][1][0][0]; *(f32x4*)(pv + 4) = acc[ai][1][0][1]; }
                if (m == 3 && fr >= 14) { float* ph = HALO + ((size_t)blk * 2 + (fr - 14)) * FF + col0; *(f32x4*)ph = acc[ai][0][3][0]; *(f32x4*)(ph + 4) = acc[ai][0][3][1]; }
            } }
    }
};
template <class Epi, class Sched, bool ALIGN_EPI = false, bool SP2 = false>
__device__ __forceinline__ void gemm_phase(PG8_LAS unsigned char* lds, const Gemm g, const Sched& S, const Epi& E) {
    const int tid = threadIdx.x, wid = __builtin_amdgcn_readfirstlane(tid >> 6), lane = tid & 63, wr = wid >> 2, wc = wid & 3, fr = lane & 15, fq = lane >> 4;
    const int K = g.K, nt = K / BK;
    unsigned voffA[2], voffB[2];
#pragma unroll
    for (int i = 0; i < 2; ++i) { int R, C; stage_rc(tid * 16 + i * 8192, R, C); const int Rb = Epi::PERM ? ((R & ~31) + perm32(R & 31)) : R;
        voffA[i] = (unsigned)(R * K + C) * 2u; voffB[i] = (unsigned)(Rb * K + C) * 2u; }
    const size_t kstep = (size_t)(BK * 2);
    const size_t hstep = (size_t)HALF * K * 2;
    const size_t tstep = 2 * hstep;
    const unsigned ldsw = (unsigned)wid * 1024u;
    const int aoff = lds_byte(wr * 64 + fr, fq * 8), boff = lds_byte(wc * 32 + fr, fq * 8);
#define PG8_SA(b, h) (((b) * 2 + (h)) * HTB)
#define PG8_SB(b, h) ((4 + (b) * 2 + (h)) * HTB)
#define PG8_STAGE(bufoff, gbase, voff) do { _Pragma("unroll") for (int _i = 0; _i < 2; ++_i) \
        __builtin_amdgcn_global_load_lds((const unsigned*)((const char*)(gbase) + (voff)[_i]), (PG8_LAS unsigned*)(lds + (bufoff) + ldsw + _i * 8192), 16, 0, 0); } while (0)
#define PG8_LDA(dst, b, h) do { _Pragma("unroll") for (int m = 0; m < 4; ++m) _Pragma("unroll") for (int k = 0; k < 2; ++k) dst[m][k] = *(const PG8_LAS bf16x8*)(lds + PG8_SA(b, h) + aoff + m * 2048 + k * 1024); } while (0)
#define PG8_LDB(dst, b, h) do { _Pragma("unroll") for (int n = 0; n < 2; ++n) _Pragma("unroll") for (int k = 0; k < 2; ++k) dst[n][k] = *(const PG8_LAS bf16x8*)(lds + PG8_SB(b, h) + boff + n * 2048 + k * 1024); } while (0)
#define PG8_MMA(ai, bj, At, Bt) do { __builtin_amdgcn_s_setprio(1); _Pragma("unroll") for (int m = 0; m < 4; ++m) _Pragma("unroll") for (int n = 0; n < 2; ++n) _Pragma("unroll") for (int k = 0; k < 2; ++k) \
        acc[ai][bj][m][n] = __builtin_amdgcn_mfma_f32_16x16x32_bf16(Bt[n][k], At[m][k], acc[ai][bj][m][n], 0, 0, 0); __builtin_amdgcn_s_setprio(0); } while (0)
#define PG8_WAIT_V(n) asm volatile("s_waitcnt vmcnt(" #n ")" ::: "memory")
#define PG8_WAIT_L(n) asm volatile("s_waitcnt lgkmcnt(" #n ")" ::: "memory")
#define PG8_BAR __builtin_amdgcn_s_barrier()
#define PG8_SCHED __builtin_amdgcn_sched_barrier(0)
    Unit cur, nxt; int ui = 0;
    if (!S.next(0, cur)) return;
    f32x4 acc[2][2][4][2];
#pragma unroll
    for (int a = 0; a < 2; ++a)
#pragma unroll
        for (int b = 0; b < 2; ++b)
#pragma unroll
            for (int m = 0; m < 4; ++m)
#pragma unroll
                for (int n = 0; n < 2; ++n) acc[a][b][m][n] = (f32x4){0.f, 0.f, 0.f, 0.f};
    bf16x8 At[4][2], B0[2][2], B1[2][2];
    const char* cA = (const char*)(cur.pn >= g.pn2 ? g.A2 : g.A) + (size_t)cur.pm * tstep; const char* cB = (const char*)g.Bt + (size_t)cur.pn * tstep;
    S.a_ready(cur);
    if constexpr (SP2) {
        PG8_STAGE(PG8_SB(0, 0), cB, voffB); PG8_STAGE(PG8_SB(0, 1), cB + hstep, voffB); PG8_STAGE(PG8_SA(0, 0), cA, voffA); PG8_STAGE(PG8_SA(0, 1), cA + hstep, voffA);
        if (wr == 1) PG8_BAR;
        PG8_WAIT_V(2); PG8_BAR;
        PG8_STAGE(PG8_SB(1, 0), cB + kstep, voffB); PG8_STAGE(PG8_SA(1, 0), cA + kstep, voffA); PG8_STAGE(PG8_SB(1, 1), cB + hstep + kstep, voffB);
        PG8_WAIT_V(6); PG8_BAR;
    } else {
        PG8_STAGE(PG8_SB(0, 0), cB, voffB); PG8_STAGE(PG8_SA(0, 0), cA, voffA); PG8_STAGE(PG8_SB(0, 1), cB + hstep, voffB); PG8_STAGE(PG8_SA(0, 1), cA + hstep, voffA);
        if (wr == 1) PG8_BAR;
        PG8_WAIT_V(4); PG8_BAR;
        PG8_STAGE(PG8_SB(1, 0), cB + kstep, voffB); PG8_STAGE(PG8_SA(1, 0), cA + kstep, voffA); PG8_STAGE(PG8_SB(1, 1), cB + hstep + kstep, voffB);
        PG8_WAIT_V(6); PG8_BAR;
    }
    for (;;) {
        const bool has_next = S.next(ui + 1, nxt);
        const char* nA = has_next ? (const char*)(nxt.pn >= g.pn2 ? g.A2 : g.A) + (size_t)nxt.pm * tstep : cA; const char* nB = has_next ? (const char*)g.Bt + (size_t)nxt.pn * tstep : cB;
        for (int t = 0; t < nt; t += 2) {
            const bool last = (t == nt - 2);
            const char* a1 = cA + (size_t)(t + 1) * kstep;
            const char* a2 = last ? nA : cA + (size_t)(t + 2) * kstep; const char* b2 = last ? nB : cB + (size_t)(t + 2) * kstep;
            const char* a3 = a2 + kstep; const char* b3 = b2 + kstep;
            if (last && has_next) S.a_ready(nxt);
            if constexpr (SP2) {
            PG8_LDB(B0, 0, 0); PG8_LDB(B1, 0, 1); PG8_SCHED; PG8_LDA(At, 0, 0); PG8_STAGE(PG8_SA(1, 1), a1 + hstep, voffA);
            PG8_WAIT_V(8); PG8_WAIT_L(0); PG8_BAR; PG8_MMA(0, 0, At, B0); PG8_MMA(0, 1, At, B1); PG8_BAR; PG8_SCHED;
            PG8_LDA(At, 0, 1); PG8_STAGE(PG8_SB(0, 0), b2, voffB); PG8_STAGE(PG8_SB(0, 1), b2 + hstep, voffB); PG8_STAGE(PG8_SA(0, 0), a2, voffA);
            PG8_WAIT_V(8); PG8_WAIT_L(0); PG8_BAR; PG8_MMA(1, 0, At, B0); PG8_MMA(1, 1, At, B1); PG8_BAR; PG8_SCHED;
            PG8_LDB(B0, 1, 0); PG8_LDB(B1, 1, 1); PG8_SCHED; PG8_LDA(At, 1, 0); PG8_STAGE(PG8_SA(0, 1), a2 + hstep, voffA);
            PG8_WAIT_V(8); PG8_WAIT_L(0); PG8_BAR; PG8_MMA(0, 0, At, B0); PG8_MMA(0, 1, At, B1); PG8_BAR; PG8_SCHED;
            PG8_LDA(At, 1, 1); PG8_STAGE(PG8_SB(1, 0), b3, voffB); PG8_STAGE(PG8_SB(1, 1), b3 + hstep, voffB); PG8_STAGE(PG8_SA(1, 0), a3, voffA);
            PG8_WAIT_V(8); PG8_WAIT_L(0); PG8_BAR; PG8_MMA(1, 0, At, B0); PG8_MMA(1, 1, At, B1); PG8_BAR; PG8_SCHED;
            } else {
            PG8_LDB(B0, 0, 0); PG8_SCHED; PG8_LDA(At, 0, 0); PG8_STAGE(PG8_SA(1, 1), a1 + hstep, voffA);
            PG8_WAIT_L(8); PG8_BAR; PG8_WAIT_L(0); PG8_MMA(0, 0, At, B0); PG8_BAR; PG8_SCHED;
            PG8_LDB(B1, 0, 1); PG8_STAGE(PG8_SB(0, 0), b2, voffB);
            PG8_BAR; PG8_WAIT_L(0); PG8_MMA(0, 1, At, B1); PG8_BAR;
            PG8_LDA(At, 0, 1); PG8_STAGE(PG8_SA(0, 0), a2, voffA);
            PG8_BAR; PG8_WAIT_L(0); PG8_MMA(1, 0, At, B0); PG8_BAR; PG8_SCHED;
            PG8_STAGE(PG8_SB(0, 1), b2 + hstep, voffB);
            PG8_WAIT_V(6); PG8_BAR; PG8_MMA(1, 1, At, B1); PG8_BAR;
            PG8_LDB(B0, 1, 0); PG8_SCHED; PG8_LDA(At, 1, 0); PG8_STAGE(PG8_SA(0, 1), a2 + hstep, voffA);
            PG8_WAIT_L(8); PG8_BAR; PG8_WAIT_L(0); PG8_MMA(0, 0, At, B0); PG8_BAR; PG8_SCHED;
            PG8_LDB(B1, 1, 1); PG8_STAGE(PG8_SB(1, 0), b3, voffB);
            PG8_BAR; PG8_WAIT_L(0); PG8_MMA(0, 1, At, B1); PG8_BAR;
            PG8_LDA(At, 1, 1); PG8_STAGE(PG8_SA(1, 0), a3, voffA);
            PG8_BAR; PG8_WAIT_L(0); PG8_MMA(1, 0, At, B0); PG8_BAR; PG8_SCHED;
            PG8_STAGE(PG8_SB(1, 1), b3 + hstep, voffB);
            PG8_WAIT_V(6); PG8_BAR; PG8_MMA(1, 1, At, B1); PG8_BAR;
            }
        }
        if constexpr (ALIGN_EPI) { if (wr == 0) PG8_BAR; }
        if constexpr (!Epi::AFTER_DRAIN) { E(acc, cur, wr, wc, fr, fq); S.done(cur); }
        if (!has_next) break;
#pragma unroll
        for (int a = 0; a < 2; ++a)
#pragma unroll
            for (int b = 0; b < 2; ++b)
#pragma unroll
                for (int m = 0; m < 4; ++m)
#pragma unroll
                    for (int n = 0; n < 2; ++n) acc[a][b][m][n] = (f32x4){0.f, 0.f, 0.f, 0.f};
        cur = nxt; cA = nA; cB = nB; ++ui;
        if constexpr (ALIGN_EPI) { if (wr == 1) PG8_BAR; }
    }
    PG8_WAIT_V(0);
    if constexpr (!ALIGN_EPI) { if (wr == 0) PG8_BAR; }
    PG8_BAR;
    if constexpr (Epi::AFTER_DRAIN) { E.fused(acc, cur, wr, wc, fr, fq, lds, wid, lane); S.done(cur); }
#undef PG8_SA
#undef PG8_SB
#undef PG8_STAGE
#undef PG8_LDA
#undef PG8_LDB
#undef PG8_MMA
#undef PG8_WAIT_V
#undef PG8_WAIT_L
#undef PG8_BAR
#undef PG8_SCHED
}
}
#define LAS __attribute__((address_space(3)))
typedef unsigned short bf16;
typedef float f32x4 __attribute__((ext_vector_type(4)));
typedef unsigned u32x4 __attribute__((ext_vector_type(4)));
typedef unsigned u32x2 __attribute__((ext_vector_type(2)));
typedef short bf16x8 __attribute__((ext_vector_type(8)));
typedef short s16x4 __attribute__((ext_vector_type(4)));
typedef float f32x16 __attribute__((ext_vector_type(16)));
using pg8::MTOK; using pg8::SEQ; using pg8::DM; using pg8::AW; using pg8::CC; using pg8::FF; using pg8::NIN; using pg8::LN_EPS; using pg8::cvt_pk_bf16; using pg8::bflo; using pg8::bfhi;
constexpr int NWAVES = 8, NTHR = 512;
constexpr size_t MiB = 1u << 20;
constexpr size_t WS_WIN = 2 * MiB, WS_WMIX = 12 * MiB, WS_WOUT = 14 * MiB, WS_WFF = 16 * MiB, WS_WDN = 28 * MiB;
constexpr size_t WS_XB = 40 * MiB, WS_Q = 104 * MiB, WS_K = 136 * MiB, WS_V = 168 * MiB, WS_U = 200 * MiB, WS_G = 232 * MiB, WS_HID = 104 * MiB;
constexpr size_t WS_AO = 360 * MiB, WS_UA = 392 * MiB, WS_MX = 424 * MiB, WS_FIXG = 360 * MiB, WS_FIXV = 372 * MiB, WS_HALO = 384 * MiB, WS_END = 488 * MiB;
constexpr int LDS_BYTES = 147456;

__device__ __forceinline__ float wave_sum(float v) {
#pragma unroll
    for (int o = 1; o < 64; o <<= 1) v += __shfl_xor(v, o);
    return v;
}
__device__ __forceinline__ float swap_max(float m) { auto rr = __builtin_amdgcn_permlane32_swap(__float_as_uint(m), __float_as_uint(m), false, false); return fmaxf(__uint_as_float(rr[0]), __uint_as_float(rr[1])); }
__device__ __forceinline__ float swap_add(float m) { auto rr = __builtin_amdgcn_permlane32_swap(__float_as_uint(m), __float_as_uint(m), false, false); return __uint_as_float(rr[0]) + __uint_as_float(rr[1]); }

__device__ __forceinline__ int dest_row(int mode, int n0) {
    if (mode == 1) {
        if (n0 >= 1536 && n0 < 2048) { const int i = n0 - 1536; return 1536 + 256 * (i >> 7) + (i & 127); }
        if (n0 >= 2048 && n0 < 2560) { const int i = n0 - 2048; return 1536 + 256 * (i >> 7) + 128 + (i & 127); }
        return n0;
    }
    if (mode == 2) {
        if (n0 < FF) return 256 * (n0 >> 7) + (n0 & 127);
        const int i = n0 - FF; return 256 * (i >> 7) + 128 + (i & 127);
    }
    return n0;
}
__device__ __forceinline__ void p0_transpose_item(const float* W, int K, int N, bf16* WT, int row_off, int mode, LAS float* scr, int item, int lane) {
    const int nblk = N / 32, kb = item / nblk, nb = item % nblk, k0 = 64 * kb, n0 = 32 * nb;
#pragma unroll 8
    for (int i = 0; i < 32; ++i) { const int kk = 2 * i + (lane >> 5); scr[kk * 33 + (lane & 31)] = W[(size_t)(k0 + kk) * N + n0 + (lane & 31)]; }
    asm volatile("s_waitcnt lgkmcnt(0)" ::: "memory");
    const int c = lane & 7; const int d0 = row_off + dest_row(mode, n0);
#pragma unroll
    for (int j = 0; j < 4; ++j) { const int n = (lane >> 3) + 8 * j; const LAS float* s = scr + (8 * c) * 33 + n;
        u32x4 o; o.x = cvt_pk_bf16(s[0 * 33], s[1 * 33]); o.y = cvt_pk_bf16(s[2 * 33], s[3 * 33]); o.z = cvt_pk_bf16(s[4 * 33], s[5 * 33]); o.w = cvt_pk_bf16(s[6 * 33], s[7 * 33]);
        *(u32x4*)(WT + (size_t)(d0 + n) * K + k0 + 8 * c) = o; }
    asm volatile("s_waitcnt lgkmcnt(0)" ::: "memory");
}

__device__ __forceinline__ void ln_rows(const float* in, const float* gam, const float* bet, float* outf, bf16* outb, int gw, int ngw, int lane) {
    f32x4 g[4], b[4];
#pragma unroll
    for (int j = 0; j < 4; ++j) { g[j] = ((const f32x4*)gam)[lane + 64 * j]; b[j] = ((const f32x4*)bet)[lane + 64 * j]; }
    for (int m = gw; m < MTOK; m += ngw) {
        const f32x4* xr = (const f32x4*)(in + (size_t)m * DM) + lane;
        f32x4 v[4]; float s = 0.f;
#pragma unroll
        for (int j = 0; j < 4; ++j) { v[j] = xr[64 * j]; s += (v[j].x + v[j].y) + (v[j].z + v[j].w); }
        const float mean = wave_sum(s) * (1.f / DM); float s2 = 0.f;
#pragma unroll
        for (int j = 0; j < 4; ++j) { v[j] = v[j] - mean; s2 += (v[j].x * v[j].x + v[j].y * v[j].y) + (v[j].z * v[j].z + v[j].w * v[j].w); }
        const float rstd = 1.f / sqrtf(wave_sum(s2) * (1.f / DM) + LN_EPS);
        f32x4* of = (f32x4*)(outf + (size_t)m * DM) + lane;
#pragma unroll
        for (int j = 0; j < 4; ++j) { v[j] = v[j] * rstd * g[j] + b[j]; of[64 * j] = v[j]; }
        if (outb) { u32x2* ob = (u32x2*)(outb + (size_t)m * DM) + lane;
#pragma unroll
            for (int j = 0; j < 4; ++j) { u32x2 w; w.x = cvt_pk_bf16(v[j].x, v[j].y); w.y = cvt_pk_bf16(v[j].z, v[j].w); ob[64 * j] = w; } }
    }
}

namespace att {
__device__ __forceinline__ unsigned offb(unsigned row, unsigned ch) { return 256u * row + 16u * (ch ^ (((row & 3) << 2) | ((row >> 2) & 3))); }
typedef short v4i16_t __attribute__((ext_vector_type(4)));
__device__ __forceinline__ s16x4 vtr(LAS const unsigned char* p) { return __builtin_bit_cast(s16x4, __builtin_amdgcn_ds_read_tr16_b64_v4i16((LAS v4i16_t*)p)); }
__device__ __forceinline__ bf16x8 pack8(float a, float b, float c, float d, float e, float f, float g, float h) {
    u32x4 w; w.x = cvt_pk_bf16(a, b); w.y = cvt_pk_bf16(c, d); w.z = cvt_pk_bf16(e, f); w.w = cvt_pk_bf16(g, h); return __builtin_bit_cast(bf16x8, w); }

__device__ __forceinline__ void attn_unit(int b, int h, int qb, const bf16* Q, const bf16* K, const bf16* V, bf16* AO, const float* gain, float lam, LAS unsigned char* lds) {
    const int tid = threadIdx.x, lane = tid & 63, l31 = lane & 31, hi = lane >> 5; const int wv = __builtin_amdgcn_readfirstlane(tid >> 6);
    const int rb = wv >> 1, map = wv & 1;
    const int qloc = 128 * qb + 32 * rb + l31;
    const int cq = 2 * qb + (rb >> 1);
    const int NT = 2 * qb + 2;
    const size_t rowbase = (size_t)b * SEQ;
    const float slope2 = exp2f(-2.0f * (float)(h + 1)) * 1.4426950408889634f;
    bf16x8 qf[4];
    { const bf16* qp = Q + (rowbase + qloc) * AW + h * 128 + map * 64 + hi * 8;
#pragma unroll
      for (int s = 0; s < 4; ++s) qf[s] = *(const bf16x8*)(qp + 16 * s); }
    const int srow0 = tid >> 4, sch = tid & 15;
    const bf16* kg = K + (rowbase + srow0) * AW + h * 128 + sch * 8; const bf16* vg = V + (rowbase + srow0) * AW + h * 128 + sch * 8;
    unsigned sdst[2];
#pragma unroll
    for (int i = 0; i < 2; ++i) { const int row = srow0 + 32 * i; sdst[i] = (unsigned)(row >> 5) * 8192u + offb(row & 31, sch); }
    u32x4 kr[2], vr[2];
#pragma unroll
    for (int i = 0; i < 2; ++i) { kr[i] = *(const u32x4*)(kg + (size_t)(32 * i) * AW); vr[i] = *(const u32x4*)(vg + (size_t)(32 * i) * AW); }
#pragma unroll
    for (int i = 0; i < 2; ++i) { *(LAS u32x4*)(lds + sdst[i]) = kr[i]; *(LAS u32x4*)(lds + 16384 + sdst[i]) = vr[i]; }
    __syncthreads();
    f32x16 O[4];
#pragma unroll
    for (int c = 0; c < 4; ++c)
#pragma unroll
        for (int r = 0; r < 16; ++r) O[c][r] = 0.f;
    float m_run = -INFINITY, l_run = 0.f;
    const unsigned xr = ((l31 & 3) << 2) | ((l31 >> 2) & 3);
    const int q4 = (lane & 15) >> 2, pp = lane & 3, blkl = (lane >> 4) & 1;
    for (int t = 0; t < NT; ++t) {
        const unsigned bufo = (unsigned)(t & 1) * 32768u;
        if (t + 1 < NT) {
#pragma unroll
            for (int i = 0; i < 2; ++i) { kr[i] = *(const u32x4*)(kg + (size_t)(64 * (t + 1) + 32 * i) * AW); vr[i] = *(const u32x4*)(vg + (size_t)(64 * (t + 1) + 32 * i) * AW); }
        }
        if (t <= cq) {
            LAS const unsigned char* kb = lds + bufo; LAS const unsigned char* vb = lds + bufo + 16384;
            f32x16 p0, p1;
#pragma unroll
            for (int r = 0; r < 16; ++r) { p0[r] = 0.f; p1[r] = 0.f; }
#pragma unroll
            for (int s = 0; s < 4; ++s) { const unsigned a = 256u * l31 + 16u * ((unsigned)(8 * map + 2 * s + hi) ^ xr);
                const bf16x8 k0 = *(LAS const bf16x8*)(kb + a), k1 = *(LAS const bf16x8*)(kb + 8192 + a);
                p0 = __builtin_amdgcn_mfma_f32_32x32x16_bf16(k0, qf[s], p0, 0, 0, 0); p1 = __builtin_amdgcn_mfma_f32_32x32x16_bf16(k1, qf[s], p1, 0, 0, 0); }
            const float dq = (float)(qloc - 64 * t - 4 * hi);
            float mx = -INFINITY;
#pragma unroll
            for (int r = 0; r < 16; ++r) { const float k0 = (float)((r & 3) + 8 * (r >> 2));
                p0[r] = p0[r] - slope2 * fabsf(dq - k0); p1[r] = p1[r] - slope2 * fabsf(dq - 32.0f - k0); mx = fmaxf(mx, fmaxf(p0[r], p1[r])); }
            mx = swap_max(mx);
            const float m_new = fmaxf(m_run, mx); const float alpha = __builtin_amdgcn_exp2f(m_run - m_new); m_run = m_new;
            float sum = 0.f;
#pragma unroll
            for (int r = 0; r < 16; ++r) { p0[r] = __builtin_amdgcn_exp2f(p0[r] - m_new); p1[r] = __builtin_amdgcn_exp2f(p1[r] - m_new); sum += p0[r] + p1[r]; }
            l_run = l_run * alpha + sum;
#pragma unroll
            for (int c = 0; c < 4; ++c)
#pragma unroll
                for (int r = 0; r < 16; ++r) O[c][r] *= alpha;
            bf16x8 pa[4];
            pa[0] = pack8(p0[0], p0[1], p0[2], p0[3], p0[4], p0[5], p0[6], p0[7]); pa[1] = pack8(p0[8], p0[9], p0[10], p0[11], p0[12], p0[13], p0[14], p0[15]);
            pa[2] = pack8(p1[0], p1[1], p1[2], p1[3], p1[4], p1[5], p1[6], p1[7]); pa[3] = pack8(p1[8], p1[9], p1[10], p1[11], p1[12], p1[13], p1[14], p1[15]);
#pragma unroll
            for (int ks4 = 0; ks4 < 4; ++ks4) { const int img = ks4 >> 1, ks = ks4 & 1;
#pragma unroll
                for (int c = 0; c < 4; ++c) {
                    const unsigned r0 = (unsigned)(16 * ks + 4 * hi + q4), r1 = r0 + 8u; const unsigned ch = (unsigned)(4 * c + 2 * blkl + (pp >> 1));
                    const s16x4 lo = vtr(vb + img * 8192 + offb(r0, ch) + 8 * (pp & 1)); const s16x4 hh = vtr(vb + img * 8192 + offb(r1, ch) + 8 * (pp & 1));
                    const bf16x8 vf = (bf16x8){lo[0], lo[1], lo[2], lo[3], hh[0], hh[1], hh[2], hh[3]};
                    O[c] = __builtin_amdgcn_mfma_f32_32x32x16_bf16(vf, pa[ks4], O[c], 0, 0, 0); } }
        }
        if (t + 1 < NT) { const unsigned nb = (unsigned)((t + 1) & 1) * 32768u;
#pragma unroll
            for (int i = 0; i < 2; ++i) { *(LAS u32x4*)(lds + nb + sdst[i]) = kr[i]; *(LAS u32x4*)(lds + nb + 16384 + sdst[i]) = vr[i]; } }
        __syncthreads();
    }
    const float inv = 1.0f / swap_add(l_run);
    LAS float* ex = (LAS float*)lds + rb * 4096;
    if (map == 1) {
#pragma unroll
        for (int c = 0; c < 4; ++c)
#pragma unroll
            for (int r = 0; r < 16; ++r) ex[(c * 16 + r) * 64 + lane] = O[c][r] * inv;
    }
    __syncthreads();
    if (map == 0) {
        float ss = 0.f;
#pragma unroll
        for (int c = 0; c < 4; ++c)
#pragma unroll
            for (int r = 0; r < 16; ++r) { const float o = O[c][r] * inv - lam * ex[(c * 16 + r) * 64 + lane]; O[c][r] = o; ss += o * o; }
        ss = swap_add(ss);
        const float rn = (1.0f / sqrtf(ss * (1.0f / 128.0f) + LN_EPS)) * 0.8f;
        bf16* op = AO + (rowbase + qloc) * AW + h * 128 + 4 * hi;
#pragma unroll
        for (int c = 0; c < 4; ++c)
#pragma unroll
            for (int g = 0; g < 4; ++g) { const int d0 = 32 * c + 8 * g; const f32x4 gn = *(const f32x4*)(gain + d0 + 4 * hi);
                u32x2 w; w.x = cvt_pk_bf16(O[c][4 * g] * rn * gn[0], O[c][4 * g + 1] * rn * gn[1]); w.y = cvt_pk_bf16(O[c][4 * g + 2] * rn * gn[2], O[c][4 * g + 3] * rn * gn[3]);
                *(u32x2*)(op + d0) = w; }
    }
    __syncthreads();
}
}

__device__ __forceinline__ void conv_phase(const bf16* U, const float* dw_w, const float* dw_b, const float* lng, const float* lnb, bf16* UA, LAS unsigned char* lds, int G) {
    const int tid = threadIdx.x, lane = tid & 63; const int wv = __builtin_amdgcn_readfirstlane(tid >> 6);
    const int ch = tid;
    float w[31];
#pragma unroll
    for (int k = 0; k < 31; ++k) w[k] = dw_w[k * CC + ch];
    const float bias = dw_b[ch];
    f32x4 g0 = *(const f32x4*)(lng + 8 * lane), g1 = *(const f32x4*)(lng + 8 * lane + 4), b0 = *(const f32x4*)(lnb + 8 * lane), b1 = *(const f32x4*)(lnb + 8 * lane + 4);
    LAS float* tile = (LAS float*)lds;
    for (int unit = blockIdx.x; unit < 512; unit += G) {
        const int b = unit >> 5, tt = unit & 31;
        for (int s = 0; s < 2; ++s) {
            const int tb = tt * 64 + 32 * s;
            float x[62];
#pragma unroll
            for (int j = 0; j < 62; ++j) { const int tau = tb - 30 + j; x[j] = 0.f; if (tau >= 0) x[j] = __uint_as_float((unsigned)U[((size_t)b * SEQ + tau) * CC + ch] << 16); }
#pragma unroll
            for (int t = 0; t < 32; ++t) { float o = bias;
#pragma unroll
                for (int k = 0; k < 31; ++k) o = fmaf(w[k], x[t + k], o);
                tile[t * CC + ch] = o; }
            __syncthreads();
#pragma unroll
            for (int i = 0; i < 4; ++i) { const int row = 4 * wv + i;
                f32x4 v0 = *(LAS const f32x4*)(tile + row * CC + 8 * lane), v1 = *(LAS const f32x4*)(tile + row * CC + 8 * lane + 4);
                const float mean = wave_sum((v0.x + v0.y) + (v0.z + v0.w) + (v1.x + v1.y) + (v1.z + v1.w)) * (1.0f / CC);
                v0 = v0 - mean; v1 = v1 - mean;
                const float var = wave_sum((v0.x * v0.x + v0.y * v0.y) + (v0.z * v0.z + v0.w * v0.w) + (v1.x * v1.x + v1.y * v1.y) + (v1.z * v1.z + v1.w * v1.w)) * (1.0f / CC);
                const float rstd = 1.0f / sqrtf(var + LN_EPS);
                v0 = v0 * rstd * g0 + b0; v1 = v1 * rstd * g1 + b1;
                float o[8] = {v0.x, v0.y, v0.z, v0.w, v1.x, v1.y, v1.z, v1.w};
#pragma unroll
                for (int e = 0; e < 8; ++e) o[e] = o[e] * pg8::sigmoidf_(o[e]);
                u32x4 wq; wq.x = cvt_pk_bf16(o[0], o[1]); wq.y = cvt_pk_bf16(o[2], o[3]); wq.z = cvt_pk_bf16(o[4], o[5]); wq.w = cvt_pk_bf16(o[6], o[7]);
                *(u32x4*)(UA + ((size_t)b * SEQ + tb + row) * CC + 8 * lane) = wq; }
            __syncthreads();
        }
    }
}

__device__ __forceinline__ void ffn_fixup(const float* FIXG, const float* FIXV, const float* HALO, const float* dww, const float* dwb, bf16* H, int gtid, int nthr) {
    constexpr int C4 = FF / 4;
    for (int idx = gtid; idx < 512 * C4; idx += nthr) {
        const int blk = idx / C4, c4 = (idx % C4) * 4;
        const f32x4 G0 = *(const f32x4*)(FIXG + ((size_t)blk * 2) * FF + c4), G1 = *(const f32x4*)(FIXG + ((size_t)blk * 2 + 1) * FF + c4);
        const f32x4 V0 = *(const f32x4*)(FIXV + ((size_t)blk * 2) * FF + c4), V1 = *(const f32x4*)(FIXV + ((size_t)blk * 2 + 1) * FF + c4);
        f32x4 H0 = (f32x4){0.f, 0.f, 0.f, 0.f}, H1 = H0;
        if ((blk & 31) != 0) { H0 = *(const f32x4*)(HALO + ((size_t)(blk - 1) * 2) * FF + c4); H1 = *(const f32x4*)(HALO + ((size_t)(blk - 1) * 2 + 1) * FF + c4); }
        const f32x4 w0 = *(const f32x4*)(dww + c4), w1 = *(const f32x4*)(dww + FF + c4), w2 = *(const f32x4*)(dww + 2 * FF + c4), bb = *(const f32x4*)(dwb + c4);
        const f32x4 gc0 = bb + w0 * H0 + w1 * H1 + w2 * G0, gc1 = bb + w0 * H1 + w1 * G0 + w2 * G1;
        const pg8::f32x2 a0 = pg8::gelu_pk((pg8::f32x2){gc0[0], gc0[1]}), a1 = pg8::gelu_pk((pg8::f32x2){gc0[2], gc0[3]}), c0 = pg8::gelu_pk((pg8::f32x2){gc1[0], gc1[1]}), c1 = pg8::gelu_pk((pg8::f32x2){gc1[2], gc1[3]});
        u32x2 o0, o1; o0.x = cvt_pk_bf16(a0.x * V0[0], a0.y * V0[1]); o0.y = cvt_pk_bf16(a1.x * V0[2], a1.y * V0[3]); o1.x = cvt_pk_bf16(c0.x * V1[0], c0.y * V1[1]); o1.y = cvt_pk_bf16(c1.x * V1[2], c1.y * V1[3]);
        *(u32x2*)(H + ((size_t)blk * 64) * FF + c4) = o0; *(u32x2*)(H + ((size_t)blk * 64 + 1) * FF + c4) = o1;
    }
}
struct Args { const float* in[24]; float* out; unsigned char* ws; int ph_lo, ph_hi; };
__global__ void __launch_bounds__(NTHR, 2) fwd_kernel(Args args) {
    extern __shared__ __attribute__((aligned(16))) unsigned char lds_raw[];
    LAS unsigned char* lds = (LAS unsigned char*)lds_raw;
    cg::grid_group grid = cg::this_grid();
    const int tid = threadIdx.x, lane = tid & 63; const int wave = __builtin_amdgcn_readfirstlane(tid >> 6);
    const int G = gridDim.x, bx = blockIdx.x;
    const int gw = bx * NWAVES + wave, NGW = G * NWAVES;
    unsigned char* ws = args.ws;
    const float* x = args.in[0]; float* out = args.out;
    bf16* WinT = (bf16*)(ws + WS_WIN); bf16* WmixT = (bf16*)(ws + WS_WMIX); bf16* WoutT = (bf16*)(ws + WS_WOUT); bf16* WffT = (bf16*)(ws + WS_WFF); bf16* WdnT = (bf16*)(ws + WS_WDN);
    bf16* XB = (bf16*)(ws + WS_XB); bf16* Qb = (bf16*)(ws + WS_Q); bf16* Kb = (bf16*)(ws + WS_K); bf16* Vb = (bf16*)(ws + WS_V); bf16* Ub = (bf16*)(ws + WS_U); bf16* Gb = (bf16*)(ws + WS_G);
    bf16* HID = (bf16*)(ws + WS_HID); bf16* AO = (bf16*)(ws + WS_AO); bf16* UA = (bf16*)(ws + WS_UA); bf16* MX = (bf16*)(ws + WS_MX);
    float* FIXG = (float*)(ws + WS_FIXG); float* FIXV = (float*)(ws + WS_FIXV); float* HALO = (float*)(ws + WS_HALO);
    const int lo = args.ph_lo, hi = args.ph_hi;
#define IN(k) (lo <= (k) && (k) < hi)
#define SEAM(k) do { if (IN(k) && IN((k) + 1)) { asm volatile("s_waitcnt vmcnt(0) lgkmcnt(0)" ::: "memory"); __syncthreads(); grid.sync(); } } while (0)

    if (IN(0)) {
        LAS float* scr = (LAS float*)(lds + wave * 16384);
        constexpr int I1 = (DM / 64) * (NIN / 32), I2 = (AW / 64) * (DM / 32), I3 = I2, I4 = (DM / 64) * (DM / 32), I5 = (DM / 64) * (2 * FF / 32), I6 = (FF / 64) * (DM / 32);
        constexpr int NITEMS = I1 + I2 + I3 + I4 + I5 + I6;
        for (int it = gw; it < NITEMS; it += NGW) {
            int r = it;
            if (r < I1) { p0_transpose_item(args.in[1], DM, NIN, WinT, 0, 1, scr, r, lane); continue; } r -= I1;
            if (r < I2) { p0_transpose_item(args.in[8], AW, DM, WmixT, 0, 0, scr, r, lane); continue; } r -= I2;
            if (r < I3) { p0_transpose_item(args.in[13], CC, DM, WmixT, DM, 0, scr, r, lane); continue; } r -= I3;
            if (r < I4) { p0_transpose_item(args.in[15], DM, DM, WoutT, 0, 0, scr, r, lane); continue; } r -= I4;
            if (r < I5) { p0_transpose_item(args.in[18], DM, 2 * FF, WffT, 0, 2, scr, r, lane); continue; } r -= I5;
            p0_transpose_item(args.in[21], FF, DM, WdnT, 0, 0, scr, r, lane);
        }
        const size_t nchunk = (size_t)MTOK * DM / 8;
        for (size_t i = (size_t)bx * NTHR + tid; i < nchunk; i += (size_t)G * NTHR) {
            const f32x4 a = ((const f32x4*)x)[2 * i], b = ((const f32x4*)x)[2 * i + 1];
            u32x4 w; w.x = cvt_pk_bf16(a.x, a.y); w.y = cvt_pk_bf16(a.z, a.w); w.z = cvt_pk_bf16(b.x, b.y); w.w = cvt_pk_bf16(b.z, b.w);
            ((u32x4*)XB)[i] = w;
        }
    }
    SEAM(0);
    if (IN(1)) {
        pg8::Gemm g{XB, WinT, MTOK, NIN, DM, XB, 1 << 30}; pg8::StaticOrder S; S.init(MTOK, NIN, G, bx);
        pg8::EpiProj E{Qb, Kb, Vb, Ub, Gb, args.in[2]};
        pg8::gemm_phase<pg8::EpiProj, pg8::StaticOrder, true, true>(lds, g, S, E);
    }
    SEAM(1);
    if (IN(2)) {
        float s1 = 0.f, s2 = 0.f;
        { const float a = args.in[3][lane] * args.in[4][lane], b = args.in[5][lane] * args.in[6][lane]; s1 = wave_sum(a); s2 = wave_sum(b); }
        const float lam = __expf(s1) - __expf(s2) + 0.2f;
        for (int i = 0;; ++i) {
            const int id = i * G + bx; if (id >= 1024) break;
            int bh, qb;
            if (G == 256) { const int s = bx & 3; bh = bx >> 2; qb = (i == 0) ? s : (i == 1) ? 7 - s : (i == 2) ? 8 + s : 15 - s; }
            else { bh = id >> 4; qb = id & 15; }
            att::attn_unit(bh >> 2, bh & 3, qb, Qb, Kb, Vb, AO, args.in[7], lam, lds);
        }
        conv_phase(Ub, args.in[9], args.in[10], args.in[11], args.in[12], UA, lds, G);
    }
    SEAM(2);
    if (IN(3)) {
        pg8::Gemm g{AO, WmixT, MTOK, 2 * DM, AW, UA, 4}; pg8::MixOrder S{G, bx};
        pg8::EpiMix E{Gb, MX, args.in[14]};
        pg8::gemm_phase<pg8::EpiMix, pg8::MixOrder, true, true>(lds, g, S, E);
    }
    SEAM(3);
    if (IN(4)) {
        pg8::Gemm g{MX, WoutT, MTOK, DM, DM, MX, 1 << 30}; pg8::StaticOrder S; S.init(MTOK, DM, G, bx);
        pg8::EpiRes E{x, out};
        pg8::gemm_phase<pg8::EpiRes, pg8::StaticOrder, true, true>(lds, g, S, E);
    }
    SEAM(4);
    if (IN(5)) ln_rows(out, args.in[16], args.in[17], out, XB, gw, NGW, lane);
    SEAM(5);
    if (IN(6)) {
        pg8::Gemm g{XB, WffT, MTOK, 2 * FF, DM, XB, 1 << 30}; pg8::StaticOrder S; S.init(MTOK, 2 * FF, G, bx);
        pg8::EpiFfn E{HID, args.in[19], args.in[20], FIXG, FIXV, HALO};
        pg8::gemm_phase<pg8::EpiFfn, pg8::StaticOrder, true, true>(lds, g, S, E);
    }
    SEAM(6);
    if (IN(7)) ffn_fixup(FIXG, FIXV, HALO, args.in[19], args.in[20], HID, bx * NTHR + tid, G * NTHR);
    SEAM(7);
    if (IN(8)) {
        pg8::Gemm g{HID, WdnT, MTOK, DM, FF, HID, 1 << 30}; pg8::StaticOrder S; S.init(MTOK, DM, G, bx);
        pg8::EpiRes E{out, out};
        pg8::gemm_phase<pg8::EpiRes, pg8::StaticOrder, true, true>(lds, g, S, E);
    }
    SEAM(8);
    if (IN(9)) ln_rows(out, args.in[22], args.in[23], out, nullptr, gw, NGW, lane);
#undef IN
#undef SEAM
}


#ifndef DBG_MODE
#define DBG_MODE 0
#endif
__global__ void dbg_sum(unsigned char* ws, float* out, int mode) {
    const size_t i = (size_t)blockIdx.x * blockDim.x + threadIdx.x;
    const size_t N16 = (size_t)MTOK * 512;
    float v = 0.f;
    if (mode == 1) { const bf16* Q = (const bf16*)(ws + WS_Q); const bf16* G = (const bf16*)(ws + WS_G);
        v = bflo(Q[i & (N16 - 1)]) + bflo(Q[N16 + (i & (N16 - 1))]) + bflo(Q[2 * N16 + (i & (N16 - 1))]) + bflo(Q[3 * N16 + (i & (N16 - 1))]) + bflo(G[i]) + bflo(G[i + 2 * N16]); }
    if (mode == 2) { const bf16* A = (const bf16*)(ws + WS_AO); v = bflo(A[i & (N16 - 1)]) + ((i >= N16) ? 100.f : 0.f); }
    if (mode == 3) { const bf16* A = (const bf16*)(ws + WS_UA); v = bflo(A[i & (N16 - 1)]); }
    if (mode == 4) { const bf16* A = (const bf16*)(ws + WS_MX); v = bflo(A[i]); }
    if (mode == 5) { const bf16* X = (const bf16*)(ws + WS_XB); v = bflo(X[i]) + bflo(((const bf16*)(ws + WS_WIN))[i % 4718592]) + bflo(((const bf16*)(ws + WS_WMIX))[i % 1048576]) + bflo(((const bf16*)(ws + WS_WOUT))[i % 1048576])
        + bflo(((const bf16*)(ws + WS_WFF))[i % 5767168]) + bflo(((const bf16*)(ws + WS_WDN))[i % 2883584]); }
    out[i] = v;
}
#ifndef DBG_HI
#define DBG_HI 10
#endif
#ifndef MK_SPLIT
#define MK_SPLIT 0
#endif
extern "C" void kernel_launch(void* const* d_in, const int* in_sizes, int n_in, void* d_out, int out_size, void* d_ws, size_t ws_size, hipStream_t stream) {
    static int grid = 0;
    if (grid == 0) {
        if (n_in != 24 || in_sizes[0] != MTOK * DM || out_size != MTOK * DM || ws_size < WS_END) { fprintf(stderr, "kernel_launch: unexpected shapes (n_in %d, in0 %d, out %d, ws %zu)\n", n_in, n_in > 0 ? in_sizes[0] : -1, out_size, ws_size); grid = -1; return; }
        int dev = 0, cus = 0, per_cu = 0;
        if (hipGetDevice(&dev) != hipSuccess || hipDeviceGetAttribute(&cus, hipDeviceAttributeMultiprocessorCount, dev) != hipSuccess) { grid = -1; return; }
        if (hipFuncSetAttribute((const void*)fwd_kernel, hipFuncAttributeMaxDynamicSharedMemorySize, LDS_BYTES) != hipSuccess) { fprintf(stderr, "kernel_launch: hipFuncSetAttribute failed\n"); grid = -1; return; }
        if (hipOccupancyMaxActiveBlocksPerMultiprocessor(&per_cu, (const void*)fwd_kernel, NTHR, LDS_BYTES) != hipSuccess || per_cu < 1) { fprintf(stderr, "kernel_launch: occupancy query says %d blocks/CU\n", per_cu); (void)hipGetLastError(); grid = -1; return; }
        grid = cus;
    }
    if (grid < 0) return;
    Args a{};
    for (int i = 0; i < 24; ++i) a.in[i] = (const float*)d_in[i];
    a.out = (float*)d_out; a.ws = (unsigned char*)d_ws;
#if MK_SPLIT
    for (int p = 0; p < DBG_HI; ++p) { a.ph_lo = p; a.ph_hi = p + 1; hipLaunchKernelGGL(fwd_kernel, dim3(grid), dim3(NTHR), LDS_BYTES, stream, a); }
    if (DBG_MODE) hipLaunchKernelGGL(dbg_sum, dim3(MTOK * DM / 256), dim3(256), 0, stream, (unsigned char*)d_ws, (float*)d_out, DBG_MODE);
#else
    a.ph_lo = 0; a.ph_hi = 10;
    void* kargs[] = {&a};
    hipError_t e = hipLaunchCooperativeKernel((const void*)fwd_kernel, dim3(grid), dim3(NTHR), kargs, LDS_BYTES, stream);
    if (e != hipSuccess) fprintf(stderr, "kernel_launch: cooperative launch failed: %s (grid %d)\n", hipGetErrorString(e), grid);
#endif
}
```
